# Optimizing an MI355X kernel written in HIP

```python
import math
import jax, jax.numpy as jnp
from jax import lax
import numpy as np

D_MODEL = 1024
BATCH = 16
SEQ = 2048
DEPTH = 2

CHUNK = 64
Q_BLOCK = 128
EPS = 1e-6
FOX_HEADS = 4
FOX_HD = 64
FOX_W = FOX_HEADS * FOX_HD
HG_HEADS = 4
HG_KD = 64
HG_VD = 64
HG_K = HG_HEADS * HG_KD
HG_V = HG_HEADS * HG_VD
DIFF_HEADS = 4
DIFF_HD = 64
DIFF_QK = DIFF_HEADS * 2 * DIFF_HD
DIFF_V = DIFF_HEADS * 2 * DIFF_HD
N_BRANCH = 3
D_FF = 4 * D_MODEL
REL_BUCKETS = 32
REL_MAX_DIST = 128
IN_SIZES = (FOX_W, FOX_W, FOX_W, FOX_HEADS,
            HG_K, HG_K, HG_V, HG_V,
            DIFF_QK, DIFF_QK, DIFF_V,
            N_BRANCH * D_MODEL)
N_IN = 3 * FOX_W + FOX_HEADS + 2 * HG_K + 2 * HG_V + 2 * DIFF_QK + DIFF_V + N_BRANCH * D_MODEL

kernel_name = "chunk_causal_gated_hybrid_fox_hgrn2_diffattn"


def _split_points():
    return np.cumsum(np.array(IN_SIZES))[:-1].tolist()


def rmsnorm(x, g):
    xf = x.astype(jnp.float32)
    y = xf * lax.rsqrt(jnp.mean(xf * xf, axis=-1, keepdims=True) + EPS)
    return (y * g.astype(jnp.float32)).astype(x.dtype)


def t5_bucket(rel):
    nb = REL_BUCKETS // 2
    n = -rel
    ret = jnp.where(n < 0, nb, 0)
    n = jnp.abs(n)
    max_exact = nb // 2
    nf = jnp.maximum(n, 1).astype(jnp.float32)
    large = max_exact + (jnp.log(nf / max_exact) / math.log(REL_MAX_DIST / max_exact)
                         * (nb - max_exact)).astype(jnp.int32)
    large = jnp.minimum(large, nb - 1)
    return ret + jnp.where(n < max_exact, n, large)


def fox_attention(q, k, v, log_f):
    S = q.shape[2]
    c = jnp.cumsum(log_f, axis=-1)
    scale = FOX_HD ** -0.5
    outs = []
    for q0 in range(0, S, Q_BLOCK):
        q1 = q0 + Q_BLOCK
        s = jnp.einsum('bhqd,bhkd->bhqk', q[:, :, q0:q1], k[:, :, :q1]).astype(jnp.float32) * scale
        s = s + c[:, :, q0:q1, None] - c[:, :, None, :q1]
        tq = jnp.arange(q0, q1)[:, None]
        tk = jnp.arange(q1)[None, :]
        s = jnp.where(tk <= tq, s, -jnp.inf)
        p = jax.nn.softmax(s, axis=-1).astype(v.dtype)
        outs.append(jnp.einsum('bhqk,bhkd->bhqd', p, v[:, :, :q1]))
    return jnp.concatenate(outs, axis=2)


def diff_attention(q, k, v, lam, rel_bias):
    S = q.shape[3]
    scale = DIFF_HD ** -0.5
    outs = []
    for q0 in range(0, S, Q_BLOCK):
        q1 = q0 + Q_BLOCK
        s = jnp.einsum('bhmqd,bhmkd->bhmqk', q[:, :, :, q0:q1], k[:, :, :, :q1]).astype(jnp.float32) * scale
        tq = jnp.arange(q0, q1)[:, None]
        tk = jnp.arange(q1)[None, :]
        bias = rel_bias.astype(jnp.float32)[t5_bucket(tk - tq)]
        s = s + jnp.transpose(bias, (2, 0, 1))[None, :, None]
        s = jnp.where((tk // CHUNK) <= (tq // CHUNK), s, -jnp.inf)
        p = jax.nn.softmax(s, axis=-1)
        a = (p[:, :, 0] - lam * p[:, :, 1]).astype(v.dtype)
        outs.append(jnp.einsum('bhqk,bhkv->bhqv', a, v[:, :, :q1]))
    return jnp.concatenate(outs, axis=2)


def hgrn2_chunkwise(q, k, i, log_f):
    B, H, S, K = q.shape
    V = i.shape[-1]
    n_chunks = S // CHUNK

    def to_chunks(t):
        return t.reshape(B, H, n_chunks, CHUNK, t.shape[-1]).transpose(2, 0, 1, 3, 4)

    causal = jnp.tril(jnp.ones((CHUNK, CHUNK), dtype=bool))[None, None, :, :, None]

    def step(state, inp):
        qt, kt, it, gt = inp
        b = jnp.cumsum(gt, axis=2)
        diff = b[:, :, :, None, :] - b[:, :, None, :, :]
        decay = jnp.exp(jnp.where(causal, diff, -jnp.inf))
        attn = jnp.sum(decay * qt[:, :, :, None, :] * kt[:, :, None, :, :], axis=-1)
        o = (jnp.einsum('bhts,bhsv->bhtv', attn, it)
             + jnp.einsum('bhtk,bhkv->bhtv', qt * jnp.exp(b), state))
        b_last = b[:, :, -1:, :]
        new_state = (jnp.exp(b_last[:, :, 0, :, None]) * state
                     + jnp.einsum('bhsk,bhsv->bhkv', kt * jnp.exp(b_last - b), it))
        return new_state, o

    state0 = jnp.zeros((B, H, K, V), jnp.float32)
    _, o = lax.scan(step, state0, (to_chunks(q), to_chunks(k), to_chunks(i), to_chunks(log_f)))
    return o.transpose(1, 2, 0, 3, 4).reshape(B, H, S, V)


def hybrid_mixer(xn, w_in, b_fox_f, b_gate, w_ba, w_bb, w_bc, w_out,
                 hg_g, diff_g, diff_lam, lower_bound, rel_bias, layer):
    B, S, _ = xn.shape
    f32 = jnp.float32
    proj = xn @ w_in
    (fq, fk, fv, ff, hq, hf, hi, hg, dq, dk, dv, gl) = jnp.split(proj, _split_points(), axis=-1)

    def heads(t, h):
        return t.reshape(B, S, h, -1).transpose(0, 2, 1, 3)

    log_f = jax.nn.log_sigmoid((ff + b_fox_f).astype(f32)).transpose(0, 2, 1)
    oa = fox_attention(heads(fq, FOX_HEADS), heads(fk, FOX_HEADS), heads(fv, FOX_HEADS), log_f)
    oa = oa.transpose(0, 2, 1, 3).reshape(B, S, FOX_W)

    raw = hf.astype(f32)
    lb = lower_bound.astype(f32)
    log_forget = jnp.logaddexp(jnp.log(lb), jnp.log1p(-lb) + jax.nn.log_sigmoid(raw))
    k_in = (1.0 - lb) * jax.nn.sigmoid(-raw)
    ob = hgrn2_chunkwise(heads(hq.astype(f32), HG_HEADS), heads(k_in, HG_HEADS),
                         heads(hi.astype(f32), HG_HEADS), heads(log_forget, HG_HEADS)).astype(xn.dtype)
    ob = rmsnorm(ob, hg_g) * jax.nn.silu(heads(hg, HG_HEADS))
    ob = ob.transpose(0, 2, 1, 3).reshape(B, S, HG_V)

    dq = dq.reshape(B, S, DIFF_HEADS, 2, DIFF_HD).transpose(0, 2, 3, 1, 4)
    dk = dk.reshape(B, S, DIFF_HEADS, 2, DIFF_HD).transpose(0, 2, 3, 1, 4)
    lam_init = 0.8 - 0.6 * math.exp(-0.3 * layer)
    lamf = diff_lam.astype(f32)
    lam = jnp.exp(jnp.sum(lamf[0] * lamf[1])) - jnp.exp(jnp.sum(lamf[2] * lamf[3])) + lam_init
    oc = diff_attention(dq, dk, heads(dv, DIFF_HEADS), lam, rel_bias)
    oc = rmsnorm(oc, diff_g) * (1.0 - lam_init)
    oc = oc.transpose(0, 2, 1, 3).reshape(B, S, DIFF_V)

    gates = jax.nn.sigmoid(gl + b_gate).reshape(B, S, N_BRANCH, D_MODEL)
    merged = (gates[:, :, 0] * (oa @ w_ba) + gates[:, :, 1] * (ob @ w_bb)
              + gates[:, :, 2] * (oc @ w_bc))
    return merged @ w_out


def setup_inputs(seed: int = 0) -> dict:
    key = jax.random.key(seed)
    ks = jax.random.split(key, 20)
    f32 = jnp.float32

    def nrm(k, shape, scale):
        return jax.random.normal(k, shape, f32) * scale

    def gain(k, shape):
        return 1.0 + 0.02 * jax.random.normal(k, shape, f32)

    return {
        "x": nrm(ks[0], (BATCH, SEQ, D_MODEL), 1.0),
        "w_in": nrm(ks[1], (DEPTH, D_MODEL, N_IN), D_MODEL ** -0.5),
        "b_fox_f": 2.0 + nrm(ks[2], (DEPTH, FOX_HEADS), 0.1),
        "b_gate": nrm(ks[3], (DEPTH, N_BRANCH * D_MODEL), 0.02),
        "w_branch_a": nrm(ks[4], (DEPTH, FOX_W, D_MODEL), FOX_W ** -0.5),
        "w_branch_b": nrm(ks[5], (DEPTH, HG_V, D_MODEL), HG_V ** -0.5),
        "w_branch_c": nrm(ks[6], (DEPTH, DIFF_V, D_MODEL), DIFF_V ** -0.5),
        "w_out": nrm(ks[7], (DEPTH, D_MODEL, D_MODEL), D_MODEL ** -0.5),
        "hg_norm_g": gain(ks[8], (DEPTH, HG_VD)),
        "diff_norm_g": gain(ks[9], (DEPTH, 2 * DIFF_HD)),
        "diff_lambda": nrm(ks[10], (DEPTH, 4, DIFF_HD), 0.1),
        "hg_lb_gamma": nrm(ks[11], (DEPTH, HG_K), 0.1),
        "rel_bias": nrm(ks[12], (REL_BUCKETS, DIFF_HEADS), 0.5),
        "g_pre_mix": gain(ks[13], (DEPTH, D_MODEL)),
        "g_post_mix": gain(ks[14], (DEPTH, D_MODEL)),
        "g_pre_mlp": gain(ks[15], (DEPTH, D_MODEL)),
        "g_post_mlp": gain(ks[16], (DEPTH, D_MODEL)),
        "w_up": nrm(ks[17], (DEPTH, D_MODEL, D_FF), D_MODEL ** -0.5),
        "w_down": nrm(ks[18], (DEPTH, D_FF, D_MODEL), D_FF ** -0.5),
    }


def reference(x, w_in, b_fox_f, b_gate, w_branch_a, w_branch_b, w_branch_c, w_out,
              hg_norm_g, diff_norm_g, diff_lambda, hg_lb_gamma, rel_bias,
              g_pre_mix, g_post_mix, g_pre_mlp, g_post_mlp, w_up, w_down):
    lb_cum = jnp.cumsum(jax.nn.softmax(hg_lb_gamma.astype(jnp.float32), axis=0), axis=0)
    lower_bounds = lb_cum - lb_cum[0:1]
    h = x
    for l in range(DEPTH):
        xn = rmsnorm(h, g_pre_mix[l])
        mix = hybrid_mixer(xn, w_in[l], b_fox_f[l], b_gate[l], w_branch_a[l], w_branch_b[l],
                           w_branch_c[l], w_out[l], hg_norm_g[l], diff_norm_g[l], diff_lambda[l],
                           lower_bounds[l], rel_bias, l)
        h = h + rmsnorm(mix, g_post_mix[l])
        xn = rmsnorm(h, g_pre_mlp[l])
        u = jax.nn.relu(xn @ w_up[l])
        h = h + rmsnorm((u * u) @ w_down[l], g_post_mlp[l])
    return h
```

```cpp
#include <hip/hip_runtime.h>
#include <cstdint>
#include <cstdio>

typedef unsigned short bf16_t;
typedef short bf16x8 __attribute__((ext_vector_type(8)));
typedef float f32x4 __attribute__((ext_vector_type(4)));
typedef unsigned u32x4 __attribute__((ext_vector_type(4)));

constexpr int BATCH = 16, SEQ = 2048, T = BATCH * SEQ, D = 1024, DFF = 4096, DEPTH = 2;
constexpr int NIN = 6404, NINP = 6656;
constexpr float EPS = 1e-6f;
constexpr float LOG2E = 1.4426950408889634f;
constexpr float QSCALE = 0.125f * LOG2E;

constexpr size_t MiB = 1u << 20;
constexpr size_t WS_CTL = 0;
constexpr size_t WS_TAB = 1 * MiB;
constexpr size_t WS_W = 2 * MiB;
constexpr size_t WL_IN = 0, WL_CAT = 13 * MiB, WL_OUT = 15 * MiB, WL_UP = 17 * MiB, WL_DOWN = 25 * MiB, WL_SIZE = 33 * MiB;
constexpr size_t WS_HB = 68 * MiB;
constexpr size_t WS_SS = 132 * MiB;
constexpr size_t WS_FLOGF = 133 * MiB;
constexpr size_t WS_FC = WS_FLOGF + 512 * 1024;
constexpr size_t WS_DST = 134 * MiB;
constexpr size_t WS_R = 136 * MiB;
constexpr size_t R_FQ = WS_R, R_FK = R_FQ + 16 * MiB, R_FV = R_FK + 16 * MiB, R_HQ = R_FV + 16 * MiB, R_HK = R_HQ + 16 * MiB,
                 R_HI = R_HK + 16 * MiB, R_HG = R_HI + 16 * MiB, R_HGF = R_HG + 16 * MiB  , R_DQ = R_HGF + 32 * MiB,
                 R_DK = R_DQ + 32 * MiB, R_DV = R_DK + 32 * MiB, R_GATES = R_DV + 32 * MiB  , R_END = R_GATES + 96 * MiB;
static_assert(R_END == 472 * MiB, "ws map");
constexpr size_t WS_U = WS_R;
constexpr size_t WS_YTMP = WS_R;
constexpr size_t WS_NEED = 472 * MiB;
constexpr int TAB_LB = 0, TAB_LAM = 512, TAB_BIAS = 1024, BIAS_W = 2112;

struct Params {
    const float* in[19];
    float* out;
    unsigned char* ws;
    int layer; int pad;
};
enum { I_X = 0, I_WIN, I_BFOX, I_BGATE, I_WA, I_WB, I_WC, I_WOUT, I_HGG, I_DIFFG, I_LAMBDA, I_LBGAMMA, I_RELB, I_GPREMIX, I_GPOSTMIX, I_GPREMLP, I_GPOSTMLP, I_WUP, I_WDOWN };

__device__ __forceinline__ float bf2f(bf16_t v) { return __uint_as_float((unsigned)v << 16); }
__device__ __forceinline__ bf16_t f2bf(float f) { unsigned u = __float_as_uint(f); return (bf16_t)((u + 0x7fffu + ((u >> 16) & 1u)) >> 16); }
__device__ __forceinline__ float sigmoidf_(float x) { return 1.f / (1.f + __expf(-x)); }
__device__ __forceinline__ float logsigmoidf_(float z) { return fminf(z, 0.f) - log1pf(__expf(-fabsf(z))); }
__device__ __forceinline__ float wave_sum(float v) {
#pragma unroll
    for (int o = 1; o < 64; o <<= 1) v += __shfl_xor(v, o);
    return v;
}
__device__ __forceinline__ float lam_init_of(int l) { return 0.8f - 0.6f * __expf(-0.3f * (float)l); }

__device__ __forceinline__ int t5_bucket(int rel) {
    int n = -rel; int ret = (n < 0) ? 16 : 0; n = n < 0 ? -n : n;
    int v;
    if (n < 8) v = n; else if (n < 12) v = 8; else if (n < 16) v = 9; else if (n < 23) v = 10; else if (n < 32) v = 11;
    else if (n < 46) v = 12; else if (n < 64) v = 13; else if (n < 91) v = 14; else v = 15;
    return ret + v;
}
__global__ void k_tables(Params P) {
    float* tab = (float*)(P.ws + WS_TAB);
    const int tid = threadIdx.x;
    const float* gam = P.in[I_LBGAMMA];
    if (tid < 256) {
        float a = gam[tid], b = gam[256 + tid], m = fmaxf(a, b);
        float ea = __expf(a - m), eb = __expf(b - m);
        tab[TAB_LB + tid] = 0.f; tab[TAB_LB + 256 + tid] = eb / (ea + eb);
    }
    if (tid < 2) {
        const float* lm = P.in[I_LAMBDA] + tid * 256;
        float s1 = 0.f, s2 = 0.f;
        for (int i = 0; i < 64; ++i) { s1 += lm[i] * lm[64 + i]; s2 += lm[128 + i] * lm[192 + i]; }
        tab[TAB_LAM + tid] = __expf(s1) - __expf(s2) + lam_init_of(tid);
    }
    const float* rb = P.in[I_RELB];
    for (int i = tid; i < 4 * BIAS_W; i += blockDim.x) {
        int h = i / BIAS_W, idx = i % BIAS_W; int rel = idx - 2047;
        tab[TAB_BIAS + i] = rb[t5_bucket(rel) * 4 + h] * LOG2E;
    }
}
__global__ __launch_bounds__(256) void k_wprep(const float* __restrict__ W, const float* __restrict__ gain, bf16_t* __restrict__ out,
                                               int Nsrc, int out_pitch, int k_off, int remap) {
    __shared__ float tile[32][33];
    const int n0 = blockIdx.x * 32, k0 = blockIdx.y * 32, tx = threadIdx.x & 31, ty = threadIdx.x >> 5;
    for (int i = ty; i < 32; i += 8) {
        const int k = k0 + i, n = n0 + tx; int ns = n;
        if (remap) ns = (n < 768) ? n : (n < 6400 ? n + 4 : (n < 6404 ? 768 + (n - 6400) : -1));
        float v = (ns >= 0 && ns < Nsrc) ? W[(size_t)k * Nsrc + ns] : 0.f;
        if (gain) v *= gain[k];
        tile[i][tx] = v;
    }
    __syncthreads();
    for (int i = ty; i < 32; i += 8) out[(size_t)(n0 + i) * out_pitch + k_off + k0 + tx] = f2bf(tile[tx][i]);
}
__global__ __launch_bounds__(256) void k_xprep(Params P) {
    const int row = blockIdx.x, tid = threadIdx.x;
    const f32x4 v = ((const f32x4*)(P.in[I_X] + (size_t)row * D))[tid];
    bf16_t* hb = (bf16_t*)(P.ws + WS_HB) + (size_t)row * D + tid * 4;
    hb[0] = f2bf(v.x); hb[1] = f2bf(v.y); hb[2] = f2bf(v.z); hb[3] = f2bf(v.w);
    float s = wave_sum(v.x * v.x + v.y * v.y + v.z * v.z + v.w * v.w);
    __shared__ float red[4];
    if ((tid & 63) == 0) red[tid >> 6] = s;
    __syncthreads();
    if (tid == 0) { float* ss = (float*)(P.ws + WS_SS) + (size_t)row * 4; ss[0] = red[0] + red[1] + red[2] + red[3]; ss[1] = 0.f; ss[2] = 0.f; ss[3] = 0.f; }
}

__device__ __forceinline__ float row_rstd(const Params& P, int row) {
    const f32x4 s = *(const f32x4*)((const float*)(P.ws + WS_SS) + (size_t)row * 4);
    return rsqrtf((s.x + s.y + s.z + s.w) * (1.f / D) + EPS);
}
__device__ __forceinline__ void g1_elem(const Params& P, int l, int row, int c, float v) {
    const int tile = c >> 8, cc = c & 255; unsigned char* ws = P.ws; const size_t r256 = (size_t)row * 256 + cc;
    switch (tile) {
    case 0: ((bf16_t*)(ws + R_FQ))[r256] = f2bf(v * QSCALE); break;
    case 1: ((bf16_t*)(ws + R_FK))[r256] = f2bf(v); break;
    case 2: ((bf16_t*)(ws + R_FV))[r256] = f2bf(v); break;
    case 3: ((bf16_t*)(ws + R_HQ))[r256] = f2bf(v); break;
    case 4: { const float lb = ((const float*)(ws + WS_TAB))[TAB_LB + l * 256 + cc]; const float vc = fminf(fmaxf(v, -30.f), 30.f);
              const float f = lb + (1.f - lb) * sigmoidf_(vc); ((float*)(ws + R_HGF))[r256] = __logf(f);
              ((bf16_t*)(ws + R_HK))[r256] = f2bf((1.f - lb) * sigmoidf_(-vc)); break; }
    case 5: ((bf16_t*)(ws + R_HI))[r256] = f2bf(v); break;
    case 6: ((bf16_t*)(ws + R_HG))[r256] = f2bf(v * sigmoidf_(v)); break;
    case 7: case 8: ((bf16_t*)(ws + R_DQ))[(size_t)row * 512 + (c - 7 * 256)] = f2bf(v * QSCALE); break;
    case 9: case 10: ((bf16_t*)(ws + R_DK))[(size_t)row * 512 + (c - 9 * 256)] = f2bf(v); break;
    case 11: case 12: ((bf16_t*)(ws + R_DV))[(size_t)row * 512 + (c - 11 * 256)] = f2bf(v); break;
    case 25: if (cc < 4) ((float*)(ws + WS_FLOGF))[(size_t)row * 4 + cc] = LOG2E * logsigmoidf_(v + P.in[I_BFOX][l * 4 + cc]); break;
    default: { const int gc = c - 13 * 256; const float g = sigmoidf_(v + P.in[I_BGATE][l * 3072 + gc]);
               (ws + R_GATES)[(size_t)row * 3072 + gc] = (unsigned char)(int)(g * 255.f + 0.5f); break; }
    }
}
template <int MODE>
__global__ __launch_bounds__(256) void k_gemm(Params P, const bf16_t* __restrict__ A, int lda, const bf16_t* __restrict__ Bt, int ldb, int N, int K, float* ybuf) {
    const int lane = threadIdx.x & 63, wid = threadIdx.x >> 6, fr = lane & 15, fq = lane >> 4;
    const int row0 = blockIdx.y * 64 + (wid >> 1) * 32, col0 = blockIdx.x * 64 + (wid & 1) * 32;
    f32x4 acc[2][2];
#pragma unroll
    for (int i = 0; i < 2; ++i)
#pragma unroll
        for (int j = 0; j < 2; ++j) acc[i][j] = (f32x4){0.f, 0.f, 0.f, 0.f};
    const bf16_t* ap = A + (size_t)(row0 + fr) * lda + fq * 8;
    const bf16_t* bp = Bt + (size_t)(col0 + fr) * ldb + fq * 8;
    for (int k = 0; k < K; k += 32) {
        bf16x8 a[2], b[2];
#pragma unroll
        for (int i = 0; i < 2; ++i) { a[i] = *(const bf16x8*)(ap + (size_t)i * 16 * lda + k); b[i] = *(const bf16x8*)(bp + (size_t)i * 16 * ldb + k); }
#pragma unroll
        for (int i = 0; i < 2; ++i)
#pragma unroll
            for (int j = 0; j < 2; ++j) acc[i][j] = __builtin_amdgcn_mfma_f32_16x16x32_bf16(a[i], b[j], acc[i][j], 0, 0, 0);
    }
#pragma unroll
    for (int i = 0; i < 2; ++i)
#pragma unroll
        for (int r = 0; r < 4; ++r) {
            const int row = row0 + i * 16 + fq * 4 + r;
            float rs = 1.f; if (MODE == 1 || MODE == 4) rs = row_rstd(P, row);
#pragma unroll
            for (int j = 0; j < 2; ++j) {
                const int col = col0 + j * 16 + fr; const float v = acc[i][j][r] * rs;
                if (MODE == 1) g1_elem(P, P.layer, row, col, v);
                else if (MODE == 3) ybuf[(size_t)row * N + col] = v;
                else { const float u = fmaxf(v, 0.f); ((bf16_t*)(P.ws + WS_U))[(size_t)row * DFF + col] = f2bf(u * u); }
            }
        }
}
__global__ __launch_bounds__(256) void k_gemm_g2(Params P) {
    const int lane = threadIdx.x & 63, wid = threadIdx.x >> 6, fr = lane & 15, fq = lane >> 4;
    const int row0 = blockIdx.y * 64 + (wid >> 1) * 32, col0 = blockIdx.x * 64 + (wid & 1) * 32;
    const bf16_t* A = (const bf16_t*)P.out; const bf16_t* Bt = (const bf16_t*)(P.ws + WS_W + (size_t)P.layer * WL_SIZE + WL_CAT);
    bf16_t* MG = (bf16_t*)P.out + (size_t)T * D; const unsigned char* G = P.ws + R_GATES;
    f32x4 tot[2][2];
#pragma unroll
    for (int i = 0; i < 2; ++i)
#pragma unroll
        for (int j = 0; j < 2; ++j) tot[i][j] = (f32x4){0.f, 0.f, 0.f, 0.f};
    const bf16_t* ap = A + (size_t)(row0 + fr) * D + fq * 8;
    const bf16_t* bp = Bt + (size_t)(col0 + fr) * D + fq * 8;
    for (int seg = 0; seg < 3; ++seg) {
        const int kb = seg == 0 ? 0 : (seg == 1 ? 256 : 512), ke = seg == 0 ? 256 : (seg == 1 ? 512 : 1024);
        f32x4 acc[2][2];
#pragma unroll
        for (int i = 0; i < 2; ++i)
#pragma unroll
            for (int j = 0; j < 2; ++j) acc[i][j] = (f32x4){0.f, 0.f, 0.f, 0.f};
        for (int k = kb; k < ke; k += 32) {
            bf16x8 a[2], b[2];
#pragma unroll
            for (int i = 0; i < 2; ++i) { a[i] = *(const bf16x8*)(ap + (size_t)i * 16 * D + k); b[i] = *(const bf16x8*)(bp + (size_t)i * 16 * D + k); }
#pragma unroll
            for (int i = 0; i < 2; ++i)
#pragma unroll
                for (int j = 0; j < 2; ++j) acc[i][j] = __builtin_amdgcn_mfma_f32_16x16x32_bf16(a[i], b[j], acc[i][j], 0, 0, 0);
        }
#pragma unroll
        for (int i = 0; i < 2; ++i)
#pragma unroll
            for (int r = 0; r < 4; ++r)
#pragma unroll
                for (int j = 0; j < 2; ++j) {
                    const int row = row0 + i * 16 + fq * 4 + r, col = col0 + j * 16 + fr;
                    tot[i][j][r] += (float)G[(size_t)row * 3072 + seg * 1024 + col] * (1.f / 255.f) * acc[i][j][r];
                }
    }
#pragma unroll
    for (int i = 0; i < 2; ++i)
#pragma unroll
        for (int r = 0; r < 4; ++r)
#pragma unroll
            for (int j = 0; j < 2; ++j) MG[(size_t)(row0 + i * 16 + fq * 4 + r) * D + col0 + j * 16 + fr] = f2bf(tot[i][j][r]);
}
__global__ __launch_bounds__(256) void k_rownorm(Params P, const float* Y, const float* gain, int fin) {
    const int row = blockIdx.x, tid = threadIdx.x;
    const f32x4 y = ((const f32x4*)(Y + (size_t)row * D))[tid];
    __shared__ float red[8];
    float s = wave_sum(y.x * y.x + y.y * y.y + y.z * y.z + y.w * y.w);
    if ((tid & 63) == 0) red[tid >> 6] = s;
    __syncthreads();
    const float rstd = rsqrtf((red[0] + red[1] + red[2] + red[3]) * (1.f / D) + EPS);
    bf16_t* hb = (bf16_t*)(P.ws + WS_HB) + (size_t)row * D + tid * 4;
    const f32x4 g = ((const f32x4*)gain)[tid];
    f32x4 h; h.x = bf2f(hb[0]) + y.x * rstd * g.x; h.y = bf2f(hb[1]) + y.y * rstd * g.y; h.z = bf2f(hb[2]) + y.z * rstd * g.z; h.w = bf2f(hb[3]) + y.w * rstd * g.w;
    if (fin) { ((f32x4*)(P.out + (size_t)row * D))[tid] = h; return; }
    hb[0] = f2bf(h.x); hb[1] = f2bf(h.y); hb[2] = f2bf(h.z); hb[3] = f2bf(h.w);
    float s2 = wave_sum(h.x * h.x + h.y * h.y + h.z * h.z + h.w * h.w);
    if ((tid & 63) == 0) red[4 + (tid >> 6)] = s2;
    __syncthreads();
    if (tid == 0) { float* ss = (float*)(P.ws + WS_SS) + (size_t)row * 4; ss[0] = red[4] + red[5] + red[6] + red[7]; ss[1] = 0.f; ss[2] = 0.f; ss[3] = 0.f; }
}

__global__ __launch_bounds__(256) void k_fox_cumsum(Params P) {
    const int bh = blockIdx.x, b = bh >> 2, h = bh & 3, tid = threadIdx.x;
    const float* lf = (const float*)(P.ws + WS_FLOGF); float* fc = (float*)(P.ws + WS_FC) + (size_t)bh * SEQ;
    float v[8]; float s = 0.f;
#pragma unroll
    for (int i = 0; i < 8; ++i) { v[i] = lf[(size_t)(b * SEQ + tid * 8 + i) * 4 + h]; s += v[i]; v[i] = s; }
    __shared__ float part[256];
    part[tid] = s; __syncthreads();
    for (int o = 1; o < 256; o <<= 1) { float t = (tid >= o) ? part[tid - o] : 0.f; __syncthreads(); part[tid] += t; __syncthreads(); }
    const float base = part[tid] - s;
#pragma unroll
    for (int i = 0; i < 8; ++i) fc[tid * 8 + i] = base + v[i];
}
__global__ __launch_bounds__(64) void k_fox_naive(Params P) {
    const int idx = blockIdx.x * 64 + threadIdx.x, q = idx & (SEQ - 1), bh = idx >> 11, b = bh >> 2, h = bh & 3;
    const bf16_t* Q = (const bf16_t*)(P.ws + R_FQ); const bf16_t* Kb = (const bf16_t*)(P.ws + R_FK); const bf16_t* Vb = (const bf16_t*)(P.ws + R_FV);
    const float* fc = (const float*)(P.ws + WS_FC) + (size_t)bh * SEQ;
    float qv[64], acc[64];
#pragma unroll
    for (int d = 0; d < 64; ++d) { qv[d] = bf2f(Q[(size_t)(b * SEQ + q) * 256 + h * 64 + d]); acc[d] = 0.f; }
    const float cq = fc[q]; float m = -INFINITY, l = 0.f;
    const int qmax = q | 63;
    for (int k = 0; k <= qmax; ++k) {
        const bf16_t* kr = Kb + (size_t)(b * SEQ + k) * 256 + h * 64; const bf16_t* vr = Vb + (size_t)(b * SEQ + k) * 256 + h * 64;
        float s = 0.f;
#pragma unroll
        for (int d = 0; d < 64; ++d) s += qv[d] * bf2f(kr[d]);
        s += cq - fc[k];
        if (k > q) s = -INFINITY;
        const float mn = fmaxf(m, s), al = exp2f(m - mn), p = exp2f(s - mn);
        l = l * al + p;
#pragma unroll
        for (int d = 0; d < 64; ++d) acc[d] = acc[d] * al + p * bf2f(vr[d]);
        m = mn;
    }
    bf16_t* O = (bf16_t*)P.out + (size_t)(b * SEQ + q) * D + h * 64; const float il = 1.f / l;
#pragma unroll
    for (int d = 0; d < 64; ++d) O[d] = f2bf(acc[d] * il);
}
__global__ __launch_bounds__(64) void k_diff_stats(Params P) {
    const int idx = blockIdx.x * 64 + threadIdx.x, q = idx & (SEQ - 1), mm = (idx >> 11) & 1, bh = idx >> 12, b = bh >> 2, h = bh & 3;
    const bf16_t* Q = (const bf16_t*)(P.ws + R_DQ); const bf16_t* Kb = (const bf16_t*)(P.ws + R_DK);
    const float* bias = (const float*)(P.ws + WS_TAB) + TAB_BIAS + h * BIAS_W;
    float qv[64];
#pragma unroll
    for (int d = 0; d < 64; ++d) qv[d] = bf2f(Q[(size_t)(b * SEQ + q) * 512 + h * 128 + mm * 64 + d]);
    float m = -INFINITY, l = 0.f; const int kend = (q | 63) + 1;
    for (int k = 0; k < kend; ++k) {
        const bf16_t* kr = Kb + (size_t)(b * SEQ + k) * 512 + h * 128 + mm * 64;
        float s = 0.f;
#pragma unroll
        for (int d = 0; d < 64; ++d) s += qv[d] * bf2f(kr[d]);
        s += bias[k - q + 2047];
        const float mn = fmaxf(m, s); l = l * exp2f(m - mn) + exp2f(s - mn); m = mn;
    }
    float* st = (float*)(P.ws + WS_DST);
    st[(size_t)(bh * 2 + mm) * SEQ + q] = m; st[(size_t)(128 + bh * 2 + mm) * SEQ + q] = l;
}
__global__ __launch_bounds__(64) void k_diff_out(Params P) {
    const int idx = blockIdx.x * 64 + threadIdx.x, vc = idx & 3, q = (idx >> 2) & (SEQ - 1), bh = idx >> 13, b = bh >> 2, h = bh & 3, l = P.layer;
    const bf16_t* Q = (const bf16_t*)(P.ws + R_DQ); const bf16_t* Kb = (const bf16_t*)(P.ws + R_DK); const bf16_t* Vb = (const bf16_t*)(P.ws + R_DV);
    const float* tab = (const float*)(P.ws + WS_TAB); const float* bias = tab + TAB_BIAS + h * BIAS_W; const float lam = tab[TAB_LAM + l];
    const float* st = (const float*)(P.ws + WS_DST);
    const float m0 = st[(size_t)(bh * 2) * SEQ + q], m1 = st[(size_t)(bh * 2 + 1) * SEQ + q];
    const float il0 = 1.f / st[(size_t)(128 + bh * 2) * SEQ + q], il1 = lam / st[(size_t)(128 + bh * 2 + 1) * SEQ + q];
    float q0[64], q1[64], acc[32];
#pragma unroll
    for (int d = 0; d < 64; ++d) { q0[d] = bf2f(Q[(size_t)(b * SEQ + q) * 512 + h * 128 + d]); q1[d] = bf2f(Q[(size_t)(b * SEQ + q) * 512 + h * 128 + 64 + d]); }
#pragma unroll
    for (int j = 0; j < 32; ++j) acc[j] = 0.f;
    const int kend = (q | 63) + 1;
    for (int k = 0; k < kend; ++k) {
        const bf16_t* kr = Kb + (size_t)(b * SEQ + k) * 512 + h * 128; const bf16_t* vr = Vb + (size_t)(b * SEQ + k) * 512 + h * 128 + vc * 32;
        float s0 = 0.f, s1 = 0.f;
#pragma unroll
        for (int d = 0; d < 64; ++d) { s0 += q0[d] * bf2f(kr[d]); s1 += q1[d] * bf2f(kr[64 + d]); }
        const float bb = bias[k - q + 2047];
        const float a = exp2f(s0 + bb - m0) * il0 - exp2f(s1 + bb - m1) * il1;
#pragma unroll
        for (int j = 0; j < 32; ++j) acc[j] += a * bf2f(vr[j]);
    }
    float ss = 0.f;
#pragma unroll
    for (int j = 0; j < 32; ++j) ss += acc[j] * acc[j];
    ss += __shfl_xor(ss, 1); ss += __shfl_xor(ss, 2);
    const float sc = rsqrtf(ss * (1.f / 128.f) + EPS) * (1.f - lam_init_of(l));
    const float* dg = P.in[I_DIFFG] + l * 128 + vc * 32;
    bf16_t* O = (bf16_t*)P.out + (size_t)(b * SEQ + q) * D + 512 + h * 128 + vc * 32;
#pragma unroll
    for (int j = 0; j < 32; ++j) O[j] = f2bf(acc[j] * sc * dg[j]);
}
__global__ __launch_bounds__(64) void k_hgrn_naive(Params P) {
    const int bh = blockIdx.x, b = bh >> 2, h = bh & 3, lane = threadIdx.x, l = P.layer;
    const bf16_t* HQ = (const bf16_t*)(P.ws + R_HQ); const bf16_t* HK = (const bf16_t*)(P.ws + R_HK); const bf16_t* HI = (const bf16_t*)(P.ws + R_HI);
    const bf16_t* HG = (const bf16_t*)(P.ws + R_HG); const float* HGF = (const float*)(P.ws + R_HGF);
    const float gg = P.in[I_HGG][l * 64 + lane];
    float S[64];
#pragma unroll
    for (int k = 0; k < 64; ++k) S[k] = 0.f;
    for (int t = 0; t < SEQ; ++t) {
        const size_t r = (size_t)(b * SEQ + t) * 256 + h * 64;
        const float iv = bf2f(HI[r + lane]); float o = 0.f;
#pragma unroll
        for (int k = 0; k < 64; ++k) { const float f = __expf(HGF[r + k]); S[k] = f * S[k] + bf2f(HK[r + k]) * iv; o += S[k] * bf2f(HQ[r + k]); }
        const float ss = wave_sum(o * o);
        const float res = o * rsqrtf(ss * (1.f / 64.f) + EPS) * gg * bf2f(HG[r + lane]);
        ((bf16_t*)P.out)[(size_t)(b * SEQ + t) * D + 256 + h * 64 + lane] = f2bf(res);
    }
}

extern "C" void kernel_launch(void* const* d_in, const int* in_sizes, int n_in, void* d_out, int out_size, void* d_ws, size_t ws_size, hipStream_t stream) {
    if (n_in != 19 || out_size != T * D || ws_size < WS_NEED) { fprintf(stderr, "kernel_launch: unexpected shapes (n_in %d out %d ws %zu)\n", n_in, out_size, ws_size); return; }
    Params P{};
    for (int i = 0; i < 19; ++i) P.in[i] = (const float*)d_in[i];
    P.out = (float*)d_out; P.ws = (unsigned char*)d_ws; P.layer = 0; P.pad = 0;
    unsigned char* ws = (unsigned char*)d_ws;
    k_tables<<<1, 256, 0, stream>>>(P);
    for (int l = 0; l < DEPTH; ++l) {
        unsigned char* wl = ws + WS_W + (size_t)l * WL_SIZE;
        k_wprep<<<dim3(NINP / 32, D / 32), 256, 0, stream>>>(P.in[I_WIN] + (size_t)l * D * NIN, P.in[I_GPREMIX] + l * D, (bf16_t*)(wl + WL_IN), NIN, D, 0, 1);
        k_wprep<<<dim3(D / 32, 256 / 32), 256, 0, stream>>>(P.in[I_WA] + (size_t)l * 256 * D, nullptr, (bf16_t*)(wl + WL_CAT), D, D, 0, 0);
        k_wprep<<<dim3(D / 32, 256 / 32), 256, 0, stream>>>(P.in[I_WB] + (size_t)l * 256 * D, nullptr, (bf16_t*)(wl + WL_CAT), D, D, 256, 0);
        k_wprep<<<dim3(D / 32, 512 / 32), 256, 0, stream>>>(P.in[I_WC] + (size_t)l * 512 * D, nullptr, (bf16_t*)(wl + WL_CAT), D, D, 512, 0);
        k_wprep<<<dim3(D / 32, D / 32), 256, 0, stream>>>(P.in[I_WOUT] + (size_t)l * D * D, nullptr, (bf16_t*)(wl + WL_OUT), D, D, 0, 0);
        k_wprep<<<dim3(DFF / 32, D / 32), 256, 0, stream>>>(P.in[I_WUP] + (size_t)l * D * DFF, P.in[I_GPREMLP] + l * D, (bf16_t*)(wl + WL_UP), DFF, D, 0, 0);
        k_wprep<<<dim3(D / 32, DFF / 32), 256, 0, stream>>>(P.in[I_WDOWN] + (size_t)l * DFF * D, nullptr, (bf16_t*)(wl + WL_DOWN), D, DFF, 0, 0);
    }
    k_xprep<<<T, 256, 0, stream>>>(P);
    const bf16_t* HB = (const bf16_t*)(ws + WS_HB);
    for (int l = 0; l < DEPTH; ++l) {
        P.layer = l;
        unsigned char* wl = ws + WS_W + (size_t)l * WL_SIZE;
        k_gemm<1><<<dim3(NINP / 64, T / 64), 256, 0, stream>>>(P, HB, D, (const bf16_t*)(wl + WL_IN), D, NINP, D, nullptr);
        k_fox_cumsum<<<64, 256, 0, stream>>>(P);
        k_fox_naive<<<T * 4 / 64, 64, 0, stream>>>(P);
        k_diff_stats<<<T * 8 / 64, 64, 0, stream>>>(P);
        k_diff_out<<<T * 16 / 64, 64, 0, stream>>>(P);
        k_hgrn_naive<<<64, 64, 0, stream>>>(P);
        k_gemm_g2<<<dim3(D / 64, T / 64), 256, 0, stream>>>(P);
        k_gemm<3><<<dim3(D / 64, T / 64), 256, 0, stream>>>(P, (const bf16_t*)d_out + (size_t)T * D, D, (const bf16_t*)(wl + WL_OUT), D, D, D, (float*)(ws + WS_YTMP));
        k_rownorm<<<T, 256, 0, stream>>>(P, (const float*)(ws + WS_YTMP), P.in[I_GPOSTMIX] + l * D, 0);
        k_gemm<4><<<dim3(DFF / 64, T / 64), 256, 0, stream>>>(P, HB, D, (const bf16_t*)(wl + WL_UP), D, DFF, D, nullptr);
        k_gemm<3><<<dim3(D / 64, T / 64), 256, 0, stream>>>(P, (const bf16_t*)(ws + WS_U), DFF, (const bf16_t*)(wl + WL_DOWN), DFF, D, DFF, (float*)d_out);
        k_rownorm<<<T, 256, 0, stream>>>(P, (const float*)d_out, P.in[I_GPOSTMLP] + l * D, l == DEPTH - 1 ? 1 : 0);
    }
}
```
